# Optimizing an MI355X kernel written in HIP

```python
import math
import jax, jax.numpy as jnp
from jax import lax
import numpy as np

D_MODEL = 1024
BATCH = 32
SEQ = 2048
DEPTH = 1

CHUNK = 64
LEFT_CHUNKS = 8
BAND = (LEFT_CHUNKS + 1) * CHUNK
MIX_W = D_MODEL
GROUP_W = MIX_W // 2
ATT_HEADS = 8
HEAD_DIM = GROUP_W // ATT_HEADS
CONV_GROUPS = 8
CONV_WIDTH = 3
MAX_REL = 128
IN_COLS = 8 * GROUP_W
LN_EPS = 1e-5
ALPHA = (2.0 * DEPTH) ** 0.25
BETA = (8.0 * DEPTH) ** -0.25

kernel_name = "hybrid_chunkattn_shortconv_deepnorm"


def layer_norm(x, g, b):
    xf = x.astype(jnp.float32)
    mu = jnp.mean(xf, axis=-1, keepdims=True)
    var = jnp.mean(jnp.square(xf - mu), axis=-1, keepdims=True)
    y = (xf - mu) * lax.rsqrt(var + LN_EPS)
    return (y * g.astype(jnp.float32) + b.astype(jnp.float32)).astype(x.dtype)


def chunk_attention(q, k, v, rel_bias):
    bsz, seq, nh, dh = q.shape
    n_chunks = seq // CHUNK
    scale = 1.0 / math.sqrt(dh)
    qi = np.arange(CHUNK)[:, None] + LEFT_CHUNKS * CHUNK
    kj = np.arange(BAND)[None, :]
    rel_idx = np.clip(qi - kj, -MAX_REL, MAX_REL) + MAX_REL
    bias = rel_bias.astype(jnp.float32)[:, rel_idx]
    pad = ((0, 0), (LEFT_CHUNKS * CHUNK, 0), (0, 0), (0, 0))
    kp = jnp.pad(k, pad)
    vp = jnp.pad(v, pad)
    qc = q.reshape(bsz, n_chunks, CHUNK, nh, dh).transpose(1, 0, 2, 3, 4)
    band_off = jnp.arange(BAND) - LEFT_CHUNKS * CHUNK

    def one_chunk(args):
        c, qb = args
        start = c * CHUNK
        kb = lax.dynamic_slice_in_dim(kp, start, BAND, axis=1)
        vb = lax.dynamic_slice_in_dim(vp, start, BAND, axis=1)
        s = jnp.einsum('bqhd,bkhd->bhqk', qb, kb).astype(jnp.float32) * scale + bias[None]
        valid = (start + band_off) >= 0
        s = jnp.where(valid[None, None, None, :], s, jnp.float32(-1e30))
        p = jax.nn.softmax(s, axis=-1).astype(vb.dtype)
        return jnp.einsum('bhqk,bkhd->bqhd', p, vb)

    out = lax.map(one_chunk, (jnp.arange(n_chunks), qc))
    return out.transpose(1, 0, 2, 3, 4).reshape(bsz, seq, nh * dh)


def short_gated_conv(bg, cg, h, conv_w, conv_b):
    u = cg * h
    up = jnp.pad(u, ((0, 0), (CONV_WIDTH - 1, 0), (0, 0)))
    seq = u.shape[1]
    conv = conv_b + sum(conv_w[i] * up[:, i:i + seq] for i in range(CONV_WIDTH))
    return bg * conv


def mixer_layer(x, w_in, rel_bias, conv_w, conv_b, w_out):
    bsz, seq, _ = x.shape
    proj = jnp.einsum('bsd,de->bse', x, w_in)
    q, k, v, z_a, bg, cg, h, z_c = jnp.split(proj, 8, axis=-1)
    heads = lambda t: t.reshape(bsz, seq, ATT_HEADS, HEAD_DIM)
    y_att = chunk_attention(heads(q), heads(k), heads(v), rel_bias) * jax.nn.silu(z_a)
    y_conv = short_gated_conv(bg, cg, h, conv_w, conv_b) * jax.nn.silu(z_c)
    y = jnp.concatenate([y_att, y_conv], axis=-1)
    return jnp.einsum('bse,ed->bsd', y, w_out)


def setup_inputs(seed: int = 0) -> dict:
    key = jax.random.key(seed)
    ks = jax.random.split(key, 12)
    f32 = jnp.float32
    x = jax.random.normal(ks[0], (BATCH, SEQ, D_MODEL), f32)
    ln0_g = 1.0 + 0.01 * jax.random.normal(ks[1], (D_MODEL,), f32)
    ln0_b = 0.01 * jax.random.normal(ks[2], (D_MODEL,), f32)
    w_in = jax.random.normal(ks[3], (DEPTH, D_MODEL, IN_COLS), f32) * D_MODEL ** -0.5
    rel_bias = 0.1 * jax.random.normal(ks[4], (DEPTH, ATT_HEADS, 2 * MAX_REL + 1), f32)
    conv_w = jax.random.normal(ks[5], (DEPTH, CONV_WIDTH, GROUP_W), f32) * CONV_WIDTH ** -0.5
    conv_b = 0.01 * jax.random.normal(ks[6], (DEPTH, GROUP_W), f32)
    w_out = jax.random.normal(ks[7], (DEPTH, MIX_W, D_MODEL), f32) * (MIX_W ** -0.5) * BETA
    ln_g = 1.0 + 0.01 * jax.random.normal(ks[8], (DEPTH, D_MODEL), f32)
    ln_b = 0.01 * jax.random.normal(ks[9], (DEPTH, D_MODEL), f32)
    return {"x": x, "ln0_g": ln0_g, "ln0_b": ln0_b, "w_in": w_in, "rel_bias": rel_bias,
            "conv_w": conv_w, "conv_b": conv_b, "w_out": w_out, "ln_g": ln_g, "ln_b": ln_b}


def reference(x, ln0_g, ln0_b, w_in, rel_bias, conv_w, conv_b, w_out, ln_g, ln_b):
    x = layer_norm(x, ln0_g, ln0_b)
    for l in range(DEPTH):
        h = mixer_layer(x, w_in[l], rel_bias[l], conv_w[l], conv_b[l], w_out[l])
        x = layer_norm(ALPHA * x + h, ln_g[l], ln_b[l])
    return x
```

```cpp
#include <hip/hip_runtime.h>
#include <hip/hip_cooperative_groups.h>
#include <cstdio>
#include <cstdint>
namespace cg = cooperative_groups;
namespace pg8 {
#define PG8_LAS __attribute__((address_space(3)))
typedef unsigned short bf16_t;
typedef short bf16x8 __attribute__((ext_vector_type(8)));
typedef float f32x4 __attribute__((ext_vector_type(4)));
typedef unsigned u32x4 __attribute__((ext_vector_type(4)));
constexpr int BM = 256, BK = 64, HALF = 128, HTB = HALF * BK * 2  , STAGE_BYTES = 8 * HTB, NXCD = 8, WGM = 8;

__host__ __device__ __forceinline__ int lds_byte(int r, int c) { const int st = (r >> 4) * 2 + (c >> 5), rr = r & 15, cc = c & 31, ob = rr * 64 + cc * 2; return st * 1024 + (ob ^ (((ob >> 9) & 1) << 5)); }
__host__ __device__ __forceinline__ void stage_rc(int b, int& R, int& C) { const int st = b / 1024, sb = b % 1024, swz = sb ^ (((sb >> 9) & 1) << 5); R = (st >> 1) * 16 + swz / 64; C = (st & 1) * 32 + (swz % 64) / 2; }
__host__ __device__ __forceinline__ int perm32(int rho) { const int n = rho >> 4, i = rho & 15; return 8 * (i >> 2) + 4 * n + (i & 3); }

struct Unit { int pm, pn; };
struct Gemm { const bf16_t* A; const bf16_t* Bt; int M, N, K; };

struct StaticOrder {
    int nM, nN, nwg, G, c;
    __host__ __device__ void init(int M, int N, int G_, int c_) { nM = M / BM; nN = N / BM; nwg = nM * nN; G = G_; c = c_; }
    __host__ __device__ bool next(int i, Unit& u) const {
        const long L = (long)i * G + c; if (L >= nwg) return false;
        int wgid = (int)L; { const int q = nwg / NXCD, r = nwg % NXCD, xcd = wgid % NXCD, off = wgid / NXCD; wgid = (xcd < r ? xcd * (q + 1) : r * (q + 1) + (xcd - r) * q) + off; }
        const int nig = WGM * nN, gid = wgid / nig, fm = gid * WGM, gsz = (nM - fm) < WGM ? (nM - fm) : WGM;
        u.pm = fm + ((wgid % nig) % gsz); u.pn = (wgid % nig) / gsz; return true;
    }
    __device__ __forceinline__ void a_ready(const Unit&) const {}
    __device__ __forceinline__ void done(const Unit&) const {}
};

__device__ __forceinline__ unsigned cvt_pk_bf16(float lo, float hi) { unsigned r; asm volatile("v_cvt_pk_bf16_f32 %0, %1, %2" : "=v"(r) : "v"(lo), "v"(hi)); return r; }
typedef float f32x2 __attribute__((ext_vector_type(2)));
__device__ __forceinline__ f32x2 gelu_pk(f32x2 v) {
    const f32x2 av = __builtin_elementwise_abs(v), d = av * 0.2316418882f + 1.0f;
    f32x2 t; t.x = __builtin_amdgcn_rcpf(d.x); t.y = __builtin_amdgcn_rcpf(d.y);
    f32x2 q = t * 0.5307027145f + (-0.7265760135f); q = q * t + 0.7107068705f; q = q * t + (-0.142248368f); q = q * t + 0.127414796f; q = q * t;
    const f32x2 s = (v * v) * (-0.72134752044f);
    f32x2 e; e.x = __builtin_amdgcn_exp2f(s.x); e.y = __builtin_amdgcn_exp2f(s.y);
    const f32x2 m = v * (q * e), r = v - m;
    f32x2 o; o.x = v.x < 0.f ? m.x : r.x; o.y = v.y < 0.f ? m.y : r.y; return o;
}

template <int ACT  > struct EpiBf16 {
    static constexpr bool PERM = true, AFTER_DRAIN = false; static_assert(ACT == 0 || ACT == 1, "EpiBf16: ACT is 0 (none) or 1 (gelu_pk)");
    bf16_t* O; int ldc; const float* bias; int split_cols; size_t split_stride; float scale0;
    __device__ __forceinline__ void operator()(const f32x4 (&acc)[2][2][4][2], const Unit& u, int wr, int wc, int fr, int fq) const {
        const int row0 = u.pm * BM + wr * 64 + fr; int colt = u.pn * BM; bf16_t* base = O;
        float sc = 1.f; if (split_cols) { const int t = colt / split_cols; base += (size_t)t * split_stride; colt -= t * split_cols; if (t == 0) sc = scale0; }
        const int col0 = colt + wc * 32 + 8 * fq, bcol0 = u.pn * BM + wc * 32 + 8 * fq;
        f32x4 bv[2][2];
#pragma unroll
        for (int bj = 0; bj < 2; ++bj)
#pragma unroll
            for (int n = 0; n < 2; ++n) bv[bj][n] = bias ? *(const f32x4*)(bias + bcol0 + bj * HALF + 4 * n) : (f32x4){0.f, 0.f, 0.f, 0.f};
#pragma unroll
        for (int ai = 0; ai < 2; ++ai)
#pragma unroll
            for (int m = 0; m < 4; ++m) { bf16_t* rowp = base + (size_t)(row0 + ai * HALF + m * 16) * ldc + col0;
#pragma unroll
                for (int bj = 0; bj < 2; ++bj) { f32x4 v0 = acc[ai][bj][m][0] + bv[bj][0], v1 = acc[ai][bj][m][1] + bv[bj][1];
                    if (ACT == 1) { f32x2 a = gelu_pk((f32x2){v0[0], v0[1]}), b = gelu_pk((f32x2){v0[2], v0[3]}), c = gelu_pk((f32x2){v1[0], v1[1]}), d = gelu_pk((f32x2){v1[2], v1[3]});
                        v0 = (f32x4){a.x, a.y, b.x, b.y}; v1 = (f32x4){c.x, c.y, d.x, d.y}; }
                    v0 = v0 * sc; v1 = v1 * sc; u32x4 w; w.x = cvt_pk_bf16(v0[0], v0[1]); w.y = cvt_pk_bf16(v0[2], v0[3]); w.z = cvt_pk_bf16(v1[0], v1[1]); w.w = cvt_pk_bf16(v1[2], v1[3]);
                    *(u32x4*)(rowp + bj * HALF) = w; } }
    }
};
__device__ __forceinline__ float bf_lo(unsigned u) { return __uint_as_float(u << 16); }
__device__ __forceinline__ float bf_hi(unsigned u) { return __uint_as_float(u & 0xffff0000u); }
struct EpiRes {
    static constexpr bool PERM = true, AFTER_DRAIN = false;
    float* out; const bf16_t* xn; int ldc; float alpha;
    __device__ __forceinline__ void operator()(const f32x4 (&acc)[2][2][4][2], const Unit& u, int wr, int wc, int fr, int fq) const {
        const int row0 = u.pm * BM + wr * 64 + fr, col0 = u.pn * BM + wc * 32 + 8 * fq;
#pragma unroll
        for (int ai = 0; ai < 2; ++ai)
#pragma unroll
            for (int m = 0; m < 4; ++m) { const size_t off = (size_t)(row0 + ai * HALF + m * 16) * ldc + col0;
#pragma unroll
                for (int bj = 0; bj < 2; ++bj) { const u32x4 xv = *(const u32x4*)(xn + off + bj * HALF);
                    const f32x4 a0 = (f32x4){bf_lo(xv.x), bf_hi(xv.x), bf_lo(xv.y), bf_hi(xv.y)}, a1 = (f32x4){bf_lo(xv.z), bf_hi(xv.z), bf_lo(xv.w), bf_hi(xv.w)};
                    *(f32x4*)(out + off + bj * HALF) = acc[ai][bj][m][0] + a0 * alpha;
                    *(f32x4*)(out + off + bj * HALF + 4) = acc[ai][bj][m][1] + a1 * alpha; } }
    }
};
struct PanelOrder {
    int nM, G, c;
    __device__ bool next(int i, Unit& u) const { const int panel = c + (i >> 2) * G; if (panel >= nM) return false; u.pm = panel; u.pn = i & 3; return true; }
    __device__ __forceinline__ void a_ready(const Unit&) const {}
    __device__ __forceinline__ void done(const Unit&) const {}
};
template <class Epi, class Sched, bool ALIGN_EPI = false, bool SP2 = false>
__device__ __forceinline__ void gemm_phase(PG8_LAS unsigned char* lds, const Gemm g, const Sched& S, const Epi& E) {
    const int tid = threadIdx.x, wid = __builtin_amdgcn_readfirstlane(tid >> 6), lane = tid & 63, wr = wid >> 2, wc = wid & 3, fr = lane & 15, fq = lane >> 4;
    const int K = g.K, nt = K / BK;
    unsigned voffA[2], voffB[2];
#pragma unroll
    for (int i = 0; i < 2; ++i) { int R, C; stage_rc(tid * 16 + i * 8192, R, C); const int Rb = Epi::PERM ? ((R & ~31) + perm32(R & 31)) : R;
        voffA[i] = (unsigned)(R * K + C) * 2u; voffB[i] = (unsigned)(Rb * K + C) * 2u; }
    const size_t kstep = (size_t)(BK * 2);
    const size_t hstep = (size_t)HALF * K * 2;
    const size_t tstep = 2 * hstep;
    const unsigned ldsw = (unsigned)wid * 1024u;
    const int aoff = lds_byte(wr * 64 + fr, fq * 8), boff = lds_byte(wc * 32 + fr, fq * 8);
#define PG8_SA(b, h) (((b) * 2 + (h)) * HTB)
#define PG8_SB(b, h) ((4 + (b) * 2 + (h)) * HTB)
#define PG8_STAGE(bufoff, gbase, voff) do { _Pragma("unroll") for (int _i = 0; _i < 2; ++_i) \
        __builtin_amdgcn_global_load_lds((const unsigned*)((const char*)(gbase) + (voff)[_i]), (PG8_LAS unsigned*)(lds + (bufoff) + ldsw + _i * 8192), 16, 0, 0); } while (0)
#define PG8_LDA(dst, b, h) do { _Pragma("unroll") for (int m = 0; m < 4; ++m) _Pragma("unroll") for (int k = 0; k < 2; ++k) dst[m][k] = *(const PG8_LAS bf16x8*)(lds + PG8_SA(b, h) + aoff + m * 2048 + k * 1024); } while (0)
#define PG8_LDB(dst, b, h) do { _Pragma("unroll") for (int n = 0; n < 2; ++n) _Pragma("unroll") for (int k = 0; k < 2; ++k) dst[n][k] = *(const PG8_LAS bf16x8*)(lds + PG8_SB(b, h) + boff + n * 2048 + k * 1024); } while (0)
#define PG8_MMA(ai, bj, At, Bt) do { __builtin_amdgcn_s_setprio(1); _Pragma("unroll") for (int m = 0; m < 4; ++m) _Pragma("unroll") for (int n = 0; n < 2; ++n) _Pragma("unroll") for (int k = 0; k < 2; ++k) \
        acc[ai][bj][m][n] = __builtin_amdgcn_mfma_f32_16x16x32_bf16(Bt[n][k], At[m][k], acc[ai][bj][m][n], 0, 0, 0); __builtin_amdgcn_s_setprio(0); } while (0)
#define PG8_WAIT_V(n) asm volatile("s_waitcnt vmcnt(" #n ")" ::: "memory")
#define PG8_WAIT_L(n) asm volatile("s_waitcnt lgkmcnt(" #n ")" ::: "memory")
#define PG8_BAR __builtin_amdgcn_s_barrier()
#define PG8_SCHED __builtin_amdgcn_sched_barrier(0)
    Unit cur, nxt; int ui = 0;
    if (!S.next(0, cur)) return;
    f32x4 acc[2][2][4][2];
#pragma unroll
    for (int a = 0; a < 2; ++a)
#pragma unroll
        for (int b = 0; b < 2; ++b)
#pragma unroll
            for (int m = 0; m < 4; ++m)
#pragma unroll
                for (int n = 0; n < 2; ++n) acc[a][b][m][n] = (f32x4){0.f, 0.f, 0.f, 0.f};
    bf16x8 At[4][2], B0[2][2], B1[2][2];
    const char* cA = (const char*)g.A + (size_t)cur.pm * tstep; const char* cB = (const char*)g.Bt + (size_t)cur.pn * tstep;
    S.a_ready(cur);
    if constexpr (SP2) {
        PG8_STAGE(PG8_SB(0, 0), cB, voffB); PG8_STAGE(PG8_SB(0, 1), cB + hstep, voffB); PG8_STAGE(PG8_SA(0, 0), cA, voffA); PG8_STAGE(PG8_SA(0, 1), cA + hstep, voffA);
        if (wr == 1) PG8_BAR;
        PG8_WAIT_V(2); PG8_BAR;
        PG8_STAGE(PG8_SB(1, 0), cB + kstep, voffB); PG8_STAGE(PG8_SA(1, 0), cA + kstep, voffA); PG8_STAGE(PG8_SB(1, 1), cB + hstep + kstep, voffB);
        PG8_WAIT_V(6); PG8_BAR;
    } else {
        PG8_STAGE(PG8_SB(0, 0), cB, voffB); PG8_STAGE(PG8_SA(0, 0), cA, voffA); PG8_STAGE(PG8_SB(0, 1), cB + hstep, voffB); PG8_STAGE(PG8_SA(0, 1), cA + hstep, voffA);
        if (wr == 1) PG8_BAR;
        PG8_WAIT_V(4); PG8_BAR;
        PG8_STAGE(PG8_SB(1, 0), cB + kstep, voffB); PG8_STAGE(PG8_SA(1, 0), cA + kstep, voffA); PG8_STAGE(PG8_SB(1, 1), cB + hstep + kstep, voffB);
        PG8_WAIT_V(6); PG8_BAR;
    }
    for (;;) {
        const bool has_next = S.next(ui + 1, nxt);
        const char* nA = has_next ? (const char*)g.A + (size_t)nxt.pm * tstep : cA; const char* nB = has_next ? (const char*)g.Bt + (size_t)nxt.pn * tstep : cB;
        for (int t = 0; t < nt; t += 2) {
            const bool last = (t == nt - 2);
            const char* a1 = cA + (size_t)(t + 1) * kstep;
            const char* a2 = last ? nA : cA + (size_t)(t + 2) * kstep; const char* b2 = last ? nB : cB + (size_t)(t + 2) * kstep;
            const char* a3 = a2 + kstep; const char* b3 = b2 + kstep;
            if (last && has_next) S.a_ready(nxt);
            if constexpr (SP2) {
            PG8_LDB(B0, 0, 0); PG8_LDB(B1, 0, 1); PG8_SCHED; PG8_LDA(At, 0, 0); PG8_STAGE(PG8_SA(1, 1), a1 + hstep, voffA);
            PG8_WAIT_V(8); PG8_WAIT_L(0); PG8_BAR; PG8_MMA(0, 0, At, B0); PG8_MMA(0, 1, At, B1); PG8_BAR; PG8_SCHED;
            PG8_LDA(At, 0, 1); PG8_STAGE(PG8_SB(0, 0), b2, voffB); PG8_STAGE(PG8_SB(0, 1), b2 + hstep, voffB); PG8_STAGE(PG8_SA(0, 0), a2, voffA);
            PG8_WAIT_V(8); PG8_WAIT_L(0); PG8_BAR; PG8_MMA(1, 0, At, B0); PG8_MMA(1, 1, At, B1); PG8_BAR; PG8_SCHED;
            PG8_LDB(B0, 1, 0); PG8_LDB(B1, 1, 1); PG8_SCHED; PG8_LDA(At, 1, 0); PG8_STAGE(PG8_SA(0, 1), a2 + hstep, voffA);
            PG8_WAIT_V(8); PG8_WAIT_L(0); PG8_BAR; PG8_MMA(0, 0, At, B0); PG8_MMA(0, 1, At, B1); PG8_BAR; PG8_SCHED;
            PG8_LDA(At, 1, 1); PG8_STAGE(PG8_SB(1, 0), b3, voffB); PG8_STAGE(PG8_SB(1, 1), b3 + hstep, voffB); PG8_STAGE(PG8_SA(1, 0), a3, voffA);
            PG8_WAIT_V(8); PG8_WAIT_L(0); PG8_BAR; PG8_MMA(1, 0, At, B0); PG8_MMA(1, 1, At, B1); PG8_BAR; PG8_SCHED;
            } else {
            PG8_LDB(B0, 0, 0); PG8_SCHED; PG8_LDA(At, 0, 0); PG8_STAGE(PG8_SA(1, 1), a1 + hstep, voffA);
            PG8_WAIT_L(8); PG8_BAR; PG8_WAIT_L(0); PG8_MMA(0, 0, At, B0); PG8_BAR; PG8_SCHED;
            PG8_LDB(B1, 0, 1); PG8_STAGE(PG8_SB(0, 0), b2, voffB);
            PG8_BAR; PG8_WAIT_L(0); PG8_MMA(0, 1, At, B1); PG8_BAR;
            PG8_LDA(At, 0, 1); PG8_STAGE(PG8_SA(0, 0), a2, voffA);
            PG8_BAR; PG8_WAIT_L(0); PG8_MMA(1, 0, At, B0); PG8_BAR; PG8_SCHED;
            PG8_STAGE(PG8_SB(0, 1), b2 + hstep, voffB);
            PG8_WAIT_V(6); PG8_BAR; PG8_MMA(1, 1, At, B1); PG8_BAR;
            PG8_LDB(B0, 1, 0); PG8_SCHED; PG8_LDA(At, 1, 0); PG8_STAGE(PG8_SA(0, 1), a2 + hstep, voffA);
            PG8_WAIT_L(8); PG8_BAR; PG8_WAIT_L(0); PG8_MMA(0, 0, At, B0); PG8_BAR; PG8_SCHED;
            PG8_LDB(B1, 1, 1); PG8_STAGE(PG8_SB(1, 0), b3, voffB);
            PG8_BAR; PG8_WAIT_L(0); PG8_MMA(0, 1, At, B1); PG8_BAR;
            PG8_LDA(At, 1, 1); PG8_STAGE(PG8_SA(1, 0), a3, voffA);
            PG8_BAR; PG8_WAIT_L(0); PG8_MMA(1, 0, At, B0); PG8_BAR; PG8_SCHED;
            PG8_STAGE(PG8_SB(1, 1), b3 + hstep, voffB);
            PG8_WAIT_V(6); PG8_BAR; PG8_MMA(1, 1, At, B1); PG8_BAR;
            }
        }
        if constexpr (ALIGN_EPI) { if (wr == 0) PG8_BAR; }
        if constexpr (!Epi::AFTER_DRAIN) { E(acc, cur, wr, wc, fr, fq); S.done(cur); }
        if (!has_next) break;
#pragma unroll
        for (int a = 0; a < 2; ++a)
#pragma unroll
            for (int b = 0; b < 2; ++b)
#pragma unroll
                for (int m = 0; m < 4; ++m)
#pragma unroll
                    for (int n = 0; n < 2; ++n) acc[a][b][m][n] = (f32x4){0.f, 0.f, 0.f, 0.f};
        cur = nxt; cA = nA; cB = nB; ++ui;
        if constexpr (ALIGN_EPI) { if (wr == 1) PG8_BAR; }
    }
    PG8_WAIT_V(0);
    if constexpr (!ALIGN_EPI) { if (wr == 0) PG8_BAR; }
    PG8_BAR;
    if constexpr (Epi::AFTER_DRAIN) { E.fused(acc, cur, wr, wc, fr, fq, lds, wid, lane); S.done(cur); }
#undef PG8_SA
#undef PG8_SB
#undef PG8_STAGE
#undef PG8_LDA
#undef PG8_LDB
#undef PG8_MMA
#undef PG8_WAIT_V
#undef PG8_WAIT_L
#undef PG8_BAR
#undef PG8_SCHED
}
}

constexpr int NB = 32, SEQ = 2048, DM = 1024, MROWS = NB * SEQ;
constexpr int GW = 512, NHEAD = 8, HD = 64, CHUNK = 64, LEFTC = 8;
constexpr int LDP = 3584;
constexpr int COL_Q = 0, COL_K = 512, COL_ZA = 1024, COL_B = 1536, COL_C = 2048, COL_H = 2560, COL_ZC = 3072;
constexpr int LDV = MROWS;
constexpr float LN_EPS = 1e-5f;
constexpr float ALPHA = 1.189207115002721f;
constexpr float LOG2E = 1.4426950408889634f;
constexpr int TABN = 320;

constexpr size_t MiB = 1u << 20;
constexpr size_t WS_W1T = 0, WS_WVT = 8 * MiB, WS_W2T = 10 * MiB, WS_XN = 16 * MiB, WS_PROJ = 144 * MiB, WS_VT = 592 * MiB, WS_Y = 656 * MiB, WS_END = 784 * MiB;

constexpr int NWAVES = 8;
constexpr int RING_BYTES = 131072, MISC_OFF = RING_BYTES, LDS_BYTES = 147456;

#define LAS __attribute__((address_space(3)))
typedef unsigned short bf16;
typedef unsigned v4u __attribute__((ext_vector_type(4)));
typedef unsigned v2u __attribute__((ext_vector_type(2)));
typedef float f32x4 __attribute__((ext_vector_type(4)));
typedef float f32x16 __attribute__((ext_vector_type(16)));
typedef short bf16x8 __attribute__((ext_vector_type(8)));
typedef float f32x2_t __attribute__((ext_vector_type(2)));
typedef __bf16 bf16x2_t __attribute__((ext_vector_type(2)));

__device__ __forceinline__ unsigned cvtpk(float lo, float hi) { f32x2_t v = {lo, hi}; bf16x2_t b = __builtin_convertvector(v, bf16x2_t); return __builtin_bit_cast(unsigned, b); }
__device__ __forceinline__ float bflo(unsigned u) { return __uint_as_float(u << 16); }
__device__ __forceinline__ float bfhi(unsigned u) { return __uint_as_float(u & 0xffff0000u); }
__device__ __forceinline__ float silu_f(float z) { return z * __builtin_amdgcn_rcpf(1.0f + __builtin_amdgcn_exp2f(-z * LOG2E)); }
__device__ __forceinline__ float wave_sum(float v) {
#pragma unroll
    for (int o = 1; o < 64; o <<= 1) v += __shfl_xor(v, o);
    return v;
}

__device__ __forceinline__ void p0_transpose_item(const float* W, int K, int N, bf16* dst  , LAS float* scr, int k0, int n0, int lane) {
#pragma unroll 8
    for (int i = 0; i < 32; ++i) { const int kk = 2 * i + (lane >> 5); scr[kk * 33 + (lane & 31)] = W[(size_t)(k0 + kk) * N + n0 + (lane & 31)]; }
    asm volatile("s_waitcnt lgkmcnt(0)" ::: "memory");
    const int c = lane & 7;
#pragma unroll
    for (int j = 0; j < 4; ++j) { const int n = (lane >> 3) + 8 * j; const LAS float* s = scr + (8 * c) * 33 + n;
        v4u o; o.x = cvtpk(s[0 * 33], s[1 * 33]); o.y = cvtpk(s[2 * 33], s[3 * 33]); o.z = cvtpk(s[4 * 33], s[5 * 33]); o.w = cvtpk(s[6 * 33], s[7 * 33]);
        *(v4u*)(dst + (size_t)n * K + k0 + 8 * c) = o; }
    asm volatile("s_waitcnt lgkmcnt(0)" ::: "memory");
}
__device__ __forceinline__ void ln_row_to_bf16(const float* xrow, const float* g, const float* bt, bf16* orow, int lane) {
    const f32x4* xr = (const f32x4*)xrow + lane;
    f32x4 v[4]; float s = 0.f;
#pragma unroll
    for (int j = 0; j < 4; ++j) { v[j] = xr[64 * j]; s += (v[j].x + v[j].y) + (v[j].z + v[j].w); }
    const float mean = wave_sum(s) * (1.f / DM); float s2 = 0.f;
#pragma unroll
    for (int j = 0; j < 4; ++j) { v[j] = v[j] - mean; s2 += (v[j].x * v[j].x + v[j].y * v[j].y) + (v[j].z * v[j].z + v[j].w * v[j].w); }
    const float rstd = 1.f / sqrtf(wave_sum(s2) * (1.f / DM) + LN_EPS);
    v2u* o8 = (v2u*)orow + lane;
#pragma unroll
    for (int j = 0; j < 4; ++j) { const f32x4 gg = ((const f32x4*)g)[lane + 64 * j], bb = ((const f32x4*)bt)[lane + 64 * j]; const f32x4 y = v[j] * rstd * gg + bb;
        v2u w; w.x = cvtpk(y.x, y.y); w.y = cvtpk(y.z, y.w); o8[64 * j] = w; }
}
__device__ __forceinline__ void ln_row_inplace(float* row, const float* g, const float* bt, int lane) {
    f32x4* xr = (f32x4*)row + lane;
    f32x4 v[4]; float s = 0.f;
#pragma unroll
    for (int j = 0; j < 4; ++j) { v[j] = xr[64 * j]; s += (v[j].x + v[j].y) + (v[j].z + v[j].w); }
    const float mean = wave_sum(s) * (1.f / DM); float s2 = 0.f;
#pragma unroll
    for (int j = 0; j < 4; ++j) { v[j] = v[j] - mean; s2 += (v[j].x * v[j].x + v[j].y * v[j].y) + (v[j].z * v[j].z + v[j].w * v[j].w); }
    const float rstd = 1.f / sqrtf(wave_sum(s2) * (1.f / DM) + LN_EPS);
#pragma unroll
    for (int j = 0; j < 4; ++j) { const f32x4 gg = ((const f32x4*)g)[lane + 64 * j], bb = ((const f32x4*)bt)[lane + 64 * j]; xr[64 * j] = v[j] * rstd * gg + bb; }
}

#define MFMA32(a, b, c) __builtin_amdgcn_mfma_f32_32x32x16_bf16((a), (b), (c), 0, 0, 0)
#ifndef NQB
#define NQB 1
#endif
__device__ __forceinline__ void attn_unit(int b, int h, int c, int qoff, const bf16* __restrict__ PJ, const bf16* __restrict__ VT, bf16* __restrict__ Y, const LAS float* tab, int lane) {
    const int q32 = lane & 31, hi = lane >> 5;
    const int pk = (q32 & 0x13) | ((q32 & 4) << 1) | ((q32 & 8) >> 1);
    const size_t row0 = (size_t)b * SEQ + (size_t)c * CHUNK + qoff;
    bf16x8 qf[NQB][4];
#pragma unroll
    for (int qb = 0; qb < NQB; ++qb)
#pragma unroll
        for (int d0 = 0; d0 < 4; ++d0) qf[qb][d0] = *(const bf16x8*)(PJ + (row0 + qb * 32 + q32) * LDP + COL_Q + h * HD + d0 * 16 + hi * 8);
    f32x16 o[NQB][2];
#pragma unroll
    for (int i = 0; i < NQB; ++i)
#pragma unroll
        for (int j = 0; j < 2; ++j)
#pragma unroll
            for (int r = 0; r < 16; ++r) o[i][j][r] = 0.f;
    float mref[NQB], lsum[NQB];
#pragma unroll
    for (int i = 0; i < NQB; ++i) { mref[i] = 0.f; lsum[i] = 0.f; }
    const int t0 = c >= LEFTC ? c - LEFTC : 0;
    const int nblk = 2 * (c - t0 + 1);
    const bf16* kp = PJ + ((size_t)b * SEQ + (size_t)t0 * CHUNK + pk) * LDP + COL_K + h * HD + hi * 8;
    const bf16* vp = VT + (size_t)(h * HD + q32) * LDV + (size_t)b * SEQ + (size_t)t0 * CHUNK + hi * 8;
    const float SC = 0.125f * LOG2E;
    const float cbias = tab[TABN - 1];
    bf16x8 kA[4], vA[2][2], kB[4];
#define LOADK(KF, blk) do { \
    _Pragma("unroll") for (int d0 = 0; d0 < 4; ++d0) KF[d0] = *(const bf16x8*)(kp + (size_t)(blk) * 32 * LDP + d0 * 16); } while (0)
#define LOADV(VF, blk) do { \
    _Pragma("unroll") for (int db = 0; db < 2; ++db) _Pragma("unroll") for (int s_ = 0; s_ < 2; ++s_) VF[db][s_] = *(const bf16x8*)(vp + (size_t)db * 32 * LDV + (blk) * 32 + s_ * 16); } while (0)
#define BLOCK(KF, VF, blk, KB, FIRST) do { \
    const int delta_ = c - (t0 + ((blk) >> 1)); \
    f32x16 s_[NQB]; \
    _Pragma("unroll") for (int qb = 0; qb < NQB; ++qb) { \
        _Pragma("unroll") for (int r = 0; r < 16; ++r) s_[qb][r] = 0.f; \
        _Pragma("unroll") for (int d0 = 0; d0 < 4; ++d0) s_[qb] = MFMA32(KF[d0], qf[qb][d0], s_[qb]); } \
    if (delta_ >= 3) { \
        _Pragma("unroll") for (int qb = 0; qb < NQB; ++qb) _Pragma("unroll") for (int r = 0; r < 16; ++r) s_[qb][r] = s_[qb][r] * SC + cbias; \
    } else { \
        _Pragma("unroll") for (int qb = 0; qb < NQB; ++qb) { const LAS float* tb_ = tab + (128 + 64 * delta_ + qoff + qb * 32 + q32 - (KB) * 32 - 8 * hi); \
            _Pragma("unroll") for (int r = 0; r < 16; ++r) s_[qb][r] = s_[qb][r] * SC + tb_[-(16 * (r >> 3) + (r & 7))]; } \
    } \
    bf16x8 pf_[NQB][2]; \
    _Pragma("unroll") for (int qb = 0; qb < NQB; ++qb) { \
        float rm_ = fmaxf(s_[qb][0], s_[qb][1]); \
        _Pragma("unroll") for (int r = 2; r < 16; ++r) rm_ = fmaxf(rm_, s_[qb][r]); \
        rm_ = fmaxf(rm_, __shfl_xor(rm_, 32)); \
        if (FIRST) { mref[qb] = rm_; } \
        else { const float dl_ = rm_ - mref[qb]; \
            if (__any(dl_ > 8.f)) { const float d_ = dl_ > 8.f ? dl_ : 0.f; mref[qb] += d_; const float f_ = __builtin_amdgcn_exp2f(-d_); lsum[qb] *= f_; \
                _Pragma("unroll") for (int r = 0; r < 16; ++r) { o[qb][0][r] *= f_; o[qb][1][r] *= f_; } } } \
        float ps_ = 0.f; \
        _Pragma("unroll") for (int r = 0; r < 16; ++r) { s_[qb][r] = __builtin_amdgcn_exp2f(s_[qb][r] - mref[qb]); ps_ += s_[qb][r]; } \
        lsum[qb] += ps_; \
        _Pragma("unroll") for (int sl = 0; sl < 2; ++sl) { v4u w_; w_.x = cvtpk(s_[qb][8 * sl + 0], s_[qb][8 * sl + 1]); w_.y = cvtpk(s_[qb][8 * sl + 2], s_[qb][8 * sl + 3]); \
            w_.z = cvtpk(s_[qb][8 * sl + 4], s_[qb][8 * sl + 5]); w_.w = cvtpk(s_[qb][8 * sl + 6], s_[qb][8 * sl + 7]); pf_[qb][sl] = __builtin_bit_cast(bf16x8, w_); } } \
    _Pragma("unroll") for (int qb = 0; qb < NQB; ++qb) _Pragma("unroll") for (int db = 0; db < 2; ++db) _Pragma("unroll") for (int sl = 0; sl < 2; ++sl) \
        o[qb][db] = MFMA32(VF[db][sl], pf_[qb][sl], o[qb][db]); } while (0)

    LOADK(kA, 0);
    for (int j = 0; j < nblk; j += 2) {
        LOADV(vA, j); LOADK(kB, j + 1);
        if (j == 0) { BLOCK(kA, vA, j, 0, true); } else { BLOCK(kA, vA, j, 0, false); }
        LOADV(vA, j + 1); if (j + 2 < nblk) LOADK(kA, j + 2);
        BLOCK(kB, vA, j + 1, 1, false);
    }
#undef LOADK
#undef LOADV
#undef BLOCK
#pragma unroll
    for (int qb = 0; qb < NQB; ++qb) {
        const float lt = lsum[qb] + __shfl_xor(lsum[qb], 32);
        const float inv = 1.0f / lt;
        const size_t row = row0 + qb * 32 + q32;
#pragma unroll
        for (int db = 0; db < 2; ++db)
#pragma unroll
            for (int g = 0; g < 4; ++g) {
                const int d = db * 32 + 8 * g + 4 * hi;
                const v2u z = *(const v2u*)(PJ + row * LDP + COL_ZA + h * HD + d);
                const float y0 = o[qb][db][4 * g + 0] * inv * silu_f(bflo(z.x)), y1 = o[qb][db][4 * g + 1] * inv * silu_f(bfhi(z.x));
                const float y2 = o[qb][db][4 * g + 2] * inv * silu_f(bflo(z.y)), y3 = o[qb][db][4 * g + 3] * inv * silu_f(bfhi(z.y));
                v2u w; w.x = cvtpk(y0, y1); w.y = cvtpk(y2, y3);
                *(v2u*)(Y + row * DM + h * HD + d) = w;
            }
    }
}

__device__ __forceinline__ void unpack8(const v4u v, float (&f)[8]) { f[0] = bflo(v.x); f[1] = bfhi(v.x); f[2] = bflo(v.y); f[3] = bfhi(v.y); f[4] = bflo(v.z); f[5] = bfhi(v.z); f[6] = bflo(v.w); f[7] = bfhi(v.w); }
__device__ __forceinline__ void conv_strip(size_t tok0, int ntok, bool seq_start, const bf16* __restrict__ PJ, bf16* __restrict__ Y, const float* __restrict__ cw, const float* __restrict__ cbv, int lane) {
    const int ch0 = lane * 8;
    float w0[8], w1[8], w2[8], bb[8], u1[8], u2[8];
#pragma unroll
    for (int e = 0; e < 8; ++e) { w0[e] = cw[ch0 + e]; w1[e] = cw[GW + ch0 + e]; w2[e] = cw[2 * GW + ch0 + e]; bb[e] = cbv[ch0 + e]; u1[e] = 0.f; u2[e] = 0.f; }
    if (!seq_start) {
        float c1[8], h1[8], c2[8], h2[8];
        unpack8(*(const v4u*)(PJ + (tok0 - 1) * LDP + COL_C + ch0), c1); unpack8(*(const v4u*)(PJ + (tok0 - 1) * LDP + COL_H + ch0), h1);
        unpack8(*(const v4u*)(PJ + (tok0 - 2) * LDP + COL_C + ch0), c2); unpack8(*(const v4u*)(PJ + (tok0 - 2) * LDP + COL_H + ch0), h2);
#pragma unroll
        for (int e = 0; e < 8; ++e) { u1[e] = c1[e] * h1[e]; u2[e] = c2[e] * h2[e]; }
    }
#pragma unroll 4
    for (int t = 0; t < ntok; ++t) {
        const bf16* pr = PJ + (tok0 + t) * LDP + ch0;
        float bv[8], cv[8], hv[8], zv[8], y[8];
        unpack8(*(const v4u*)(pr + COL_B), bv); unpack8(*(const v4u*)(pr + COL_C), cv); unpack8(*(const v4u*)(pr + COL_H), hv); unpack8(*(const v4u*)(pr + COL_ZC), zv);
#pragma unroll
        for (int e = 0; e < 8; ++e) { const float u0 = cv[e] * hv[e]; const float cvv = bb[e] + w0[e] * u2[e] + w1[e] * u1[e] + w2[e] * u0; y[e] = bv[e] * cvv * silu_f(zv[e]); u2[e] = u1[e]; u1[e] = u0; }
        v4u w; w.x = cvtpk(y[0], y[1]); w.y = cvtpk(y[2], y[3]); w.z = cvtpk(y[4], y[5]); w.w = cvtpk(y[6], y[7]);
        *(v4u*)(Y + (tok0 + t) * DM + GW + ch0) = w;
    }
}

#ifndef SKIP_ATTN
#define ATTN_CALL { const int uu = (int)u; if (NQB == 2) attn_unit(b, h, 31 - uu, 0, PJ, VT, Y, tab + h * TABN, lane); else attn_unit(b, h, 31 - (uu >> 1), (uu & 1) * 32, PJ, VT, Y, tab + h * TABN, lane); }
#else
#define ATTN_CALL
#endif
#ifndef SKIP_CONV
#define CONV_CALL const size_t tok0 = (size_t)bh * 256 + (size_t)(u - NATT) * 32; conv_strip(tok0, 32, (tok0 % SEQ) == 0, PJ, Y, a.convw, a.convb, lane);
#else
#define CONV_CALL
#endif
struct Args { const float* x; const float* ln0g; const float* ln0b; const float* win; const float* relb; const float* convw; const float* convb; const float* wout; const float* lng; const float* lnb;
              float* out; unsigned char* ws; int ph_lo, ph_hi; };
#ifndef MK_NLAUNCH
#define MK_NLAUNCH 1
#endif
constexpr int NPHASE = 4;
constexpr unsigned NATT = (NQB == 2) ? 32u : 64u;

#ifndef LB2
#define LB2 2
#endif
__global__ void __launch_bounds__(NWAVES * 64, LB2) fwd_megakernel(Args a) {
    extern __shared__ __attribute__((aligned(16))) unsigned char lds_raw[];
    LAS unsigned char* lds = (LAS unsigned char*)lds_raw;
    volatile LAS unsigned* MISC = (volatile LAS unsigned*)(lds + MISC_OFF);
    cg::grid_group grid = cg::this_grid();
    const int tid = threadIdx.x, lane = tid & 63, wave = __builtin_amdgcn_readfirstlane(tid >> 6);
    const int G = gridDim.x, bx = blockIdx.x;
    unsigned char* ws = a.ws;
    bf16* W1T = (bf16*)(ws + WS_W1T); bf16* WVT = (bf16*)(ws + WS_WVT); bf16* W2T = (bf16*)(ws + WS_W2T);
    bf16* XN = (bf16*)(ws + WS_XN); bf16* PJ = (bf16*)(ws + WS_PROJ); bf16* VT = (bf16*)(ws + WS_VT); bf16* Y = (bf16*)(ws + WS_Y);
    if (tid < 64) MISC[tid] = 0u;
    __syncthreads();
    const int lo = a.ph_lo, hi = a.ph_hi;
#ifdef ONLY_P2
#define IN(k) ((k) == 2 && lo <= 2)
#else
#define IN(k) (lo <= (k) && (k) < hi)
#endif
#define SEAM(k) do { if (IN(k) && IN((k) + 1)) grid.sync(); } while (0)

    if (IN(0)) {
        LAS float* scr = (LAS float*)(lds + wave * 16384);
        const int gw = bx * NWAVES + wave, NGW = G * NWAVES;
        constexpr int I_IN = (DM / 64) * (4096 / 32), I_OUT = (DM / 64) * (DM / 32);
        for (int it = gw; it < I_IN + I_OUT; it += NGW) {
            if (it < I_IN) { const int kb = it / 128, nb = it % 128, n0 = nb * 32, grp = n0 / GW, within = n0 % GW;
                bf16* dst = (grp == 2) ? (WVT + (size_t)within * DM) : (W1T + (size_t)((grp < 2 ? grp : grp - 1) * GW + within) * DM);
                p0_transpose_item(a.win, DM, 4096, dst, scr, kb * 64, n0, lane); }
            else { const int r = it - I_IN, kb = r / 32, nb = r % 32; p0_transpose_item(a.wout, DM, DM, W2T + (size_t)(nb * 32) * DM, scr, kb * 64, nb * 32, lane); }
        }
        for (int m = gw; m < MROWS; m += NGW) ln_row_to_bf16(a.x + (size_t)m * DM, a.ln0g, a.ln0b, XN + (size_t)m * DM, lane);
    }
    SEAM(0);

    if (IN(1)) {
        { pg8::Gemm g{XN, W1T, MROWS, LDP, DM}; pg8::StaticOrder S; S.init(MROWS, LDP, G, bx);
          pg8::EpiBf16<0> E{PJ, LDP, nullptr, 0, 0, 1.f};
          pg8::gemm_phase<pg8::EpiBf16<0>, pg8::StaticOrder, true, true>(lds, g, S, E); }
        { pg8::Gemm g{WVT, XN, GW, MROWS, DM}; pg8::StaticOrder S; S.init(GW, MROWS, G, bx);
          pg8::EpiBf16<0> E{VT, LDV, nullptr, 0, 0, 1.f};
          pg8::gemm_phase<pg8::EpiBf16<0>, pg8::StaticOrder, true, true>(lds, g, S, E); }
    }
    SEAM(1);

    if (IN(2)) {
        LAS float* tab = (LAS float*)lds;
        for (int i = tid; i < NHEAD * TABN; i += NWAVES * 64) { const int hh = i / TABN, j = i % TABN; tab[i] = a.relb[hh * 257 + (j < 256 ? j : 256)] * LOG2E; }
        __syncthreads();
        int iter = 0;
        for (int bh = bx; bh < NB * NHEAD; bh += G, ++iter) {
            const int b = bh >> 3, h = bh & 7;
            for (;;) {
                unsigned u = 0;
                if (lane == 0) u = __hip_atomic_fetch_add((LAS unsigned*)&MISC[16 + (iter & 15)], 1u, __ATOMIC_RELAXED, __HIP_MEMORY_SCOPE_WORKGROUP);
                u = __builtin_amdgcn_readfirstlane(u);
                if (u >= NATT + 8u) break;
                if (u < NATT) { ATTN_CALL }
                else { CONV_CALL }
            }
        }
        __syncthreads();
    }
    SEAM(2);

    if (IN(3)) {
        pg8::Gemm g{Y, W2T, MROWS, DM, DM}; pg8::PanelOrder S{MROWS / 256, G, bx};
        pg8::EpiRes E{a.out, XN, DM, ALPHA};
        pg8::gemm_phase<pg8::EpiRes, pg8::PanelOrder, true, true>(lds, g, S, E);
        asm volatile("s_waitcnt vmcnt(0)" ::: "memory");
        __syncthreads();
        __builtin_amdgcn_fence(__ATOMIC_ACQUIRE, "agent");
        for (int panel = bx; panel < MROWS / 256; panel += G)
            for (int r = wave; r < 256; r += NWAVES) ln_row_inplace(a.out + ((size_t)panel * 256 + r) * DM, a.lng, a.lnb, lane);
    }
#undef IN
#undef SEAM
}

extern "C" void kernel_launch(void* const* d_in, const int* in_sizes, int n_in, void* d_out, int out_size, void* d_ws, size_t ws_size, hipStream_t stream) {
    static int grid = 0;
    if (grid == 0) {
        if (n_in != 10 || in_sizes[0] != MROWS * DM || out_size != MROWS * DM || ws_size < WS_END) { fprintf(stderr, "kernel_launch: unexpected shapes / workspace (n_in %d, ws %zu)\n", n_in, ws_size); grid = -1; return; }
        int dev = 0, cus = 0, per_cu = 0;
        if (hipGetDevice(&dev) != hipSuccess || hipDeviceGetAttribute(&cus, hipDeviceAttributeMultiprocessorCount, dev) != hipSuccess) { grid = -1; return; }
        if (hipFuncSetAttribute((const void*)fwd_megakernel, hipFuncAttributeMaxDynamicSharedMemorySize, LDS_BYTES) != hipSuccess) { fprintf(stderr, "kernel_launch: hipFuncSetAttribute failed\n"); grid = -1; return; }
        if (hipOccupancyMaxActiveBlocksPerMultiprocessor(&per_cu, (const void*)fwd_megakernel, NWAVES * 64, LDS_BYTES) != hipSuccess || per_cu < 1) { fprintf(stderr, "kernel_launch: occupancy query says %d\n", per_cu); per_cu = 1; }
        (void)hipGetLastError();
        grid = cus;
    }
    if (grid < 0) return;
    Args a{};
    a.x = (const float*)d_in[0]; a.ln0g = (const float*)d_in[1]; a.ln0b = (const float*)d_in[2]; a.win = (const float*)d_in[3]; a.relb = (const float*)d_in[4];
    a.convw = (const float*)d_in[5]; a.convb = (const float*)d_in[6]; a.wout = (const float*)d_in[7]; a.lng = (const float*)d_in[8]; a.lnb = (const float*)d_in[9];
    a.out = (float*)d_out; a.ws = (unsigned char*)d_ws;
    for (int li = 0; li < MK_NLAUNCH; ++li) {
        a.ph_lo = (MK_NLAUNCH == 1) ? 0 : li; a.ph_hi = (MK_NLAUNCH == 1) ? NPHASE : li + 1;
        void* args[] = {&a};
        const hipError_t e = hipLaunchCooperativeKernel((const void*)fwd_megakernel, dim3(grid), dim3(NWAVES * 64), args, LDS_BYTES, stream);
        if (e != hipSuccess) { fprintf(stderr, "kernel_launch: cooperative launch failed: %s (grid %d)\n", hipGetErrorString(e), grid); break; }
    }
}
```

```cpp
#include <hip/hip_runtime.h>
#include <hip/hip_cooperative_groups.h>
#include <cstdio>
#include <cstdint>
namespace cg = cooperative_groups;
namespace pg8 {
#define PG8_LAS __attribute__((address_space(3)))
typedef unsigned short bf16_t;
typedef short bf16x8 __attribute__((ext_vector_type(8)));
typedef float f32x4 __attribute__((ext_vector_type(4)));
typedef unsigned u32x4 __attribute__((ext_vector_type(4)));
constexpr int BM = 256, BK = 64, HALF = 128, HTB = HALF * BK * 2  , STAGE_BYTES = 8 * HTB, NXCD = 8, WGM = 8;

__host__ __device__ __forceinline__ int lds_byte(int r, int c) { const int st = (r >> 4) * 2 + (c >> 5), rr = r & 15, cc = c & 31, ob = rr * 64 + cc * 2; return st * 1024 + (ob ^ (((ob >> 9) & 1) << 5)); }
__host__ __device__ __forceinline__ void stage_rc(int b, int& R, int& C) { const int st = b / 1024, sb = b % 1024, swz = sb ^ (((sb >> 9) & 1) << 5); R = (st >> 1) * 16 + swz / 64; C = (st & 1) * 32 + (swz % 64) / 2; }
__host__ __device__ __forceinline__ int perm32(int rho) { const int n = rho >> 4, i = rho & 15; return 8 * (i >> 2) + 4 * n + (i & 3); }

struct Unit { int pm, pn; };
struct Gemm { const bf16_t* A; const bf16_t* Bt; int M, N, K; };

struct StaticOrder {
    int nM, nN, nwg, G, c;
    __host__ __device__ void init(int M, int N, int G_, int c_) { nM = M / BM; nN = N / BM; nwg = nM * nN; G = G_; c = c_; }
    __host__ __device__ bool next(int i, Unit& u) const {
        const long L = (long)i * G + c; if (L >= nwg) return false;
        int wgid = (int)L; { const int q = nwg / NXCD, r = nwg % NXCD, xcd = wgid % NXCD, off = wgid / NXCD; wgid = (xcd < r ? xcd * (q + 1) : r * (q + 1) + (xcd - r) * q) + off; }
        const int nig = WGM * nN, gid = wgid / nig, fm = gid * WGM, gsz = (nM - fm) < WGM ? (nM - fm) : WGM;
        u.pm = fm + ((wgid % nig) % gsz); u.pn = (wgid % nig) / gsz; return true;
    }
    __device__ __forceinline__ void a_ready(const Unit&) const {}
    __device__ __forceinline__ void done(const Unit&) const {}
};

__device__ __forceinline__ unsigned cvt_pk_bf16(float lo, float hi) { unsigned r; asm volatile("v_cvt_pk_bf16_f32 %0, %1, %2" : "=v"(r) : "v"(lo), "v"(hi)); return r; }
typedef float f32x2 __attribute__((ext_vector_type(2)));
__device__ __forceinline__ f32x2 gelu_pk(f32x2 v) {
    const f32x2 av = __builtin_elementwise_abs(v), d = av * 0.2316418882f + 1.0f;
    f32x2 t; t.x = __builtin_amdgcn_rcpf(d.x); t.y = __builtin_amdgcn_rcpf(d.y);
    f32x2 q = t * 0.5307027145f + (-0.7265760135f); q = q * t + 0.7107068705f; q = q * t + (-0.142248368f); q = q * t + 0.127414796f; q = q * t;
    const f32x2 s = (v * v) * (-0.72134752044f);
    f32x2 e; e.x = __builtin_amdgcn_exp2f(s.x); e.y = __builtin_amdgcn_exp2f(s.y);
    const f32x2 m = v * (q * e), r = v - m;
    f32x2 o; o.x = v.x < 0.f ? m.x : r.x; o.y = v.y < 0.f ? m.y : r.y; return o;
}

template <int ACT  > struct EpiBf16 {
    static constexpr bool PERM = true, AFTER_DRAIN = false; static_assert(ACT == 0 || ACT == 1, "EpiBf16: ACT is 0 (none) or 1 (gelu_pk)");
    bf16_t* O; int ldc; const float* bias; int split_cols; size_t split_stride; float scale0;
    __device__ __forceinline__ void operator()(const f32x4 (&acc)[2][2][4][2], const Unit& u, int wr, int wc, int fr, int fq) const {
        const int row0 = u.pm * BM + wr * 64 + fr; int colt = u.pn * BM; bf16_t* base = O;
        float sc = 1.f; if (split_cols) { const int t = colt / split_cols; base += (size_t)t * split_stride; colt -= t * split_cols; if (t == 0) sc = scale0; }
        const int col0 = colt + wc * 32 + 8 * fq, bcol0 = u.pn * BM + wc * 32 + 8 * fq;
        f32x4 bv[2][2];
#pragma unroll
        for (int bj = 0; bj < 2; ++bj)
#pragma unroll
            for (int n = 0; n < 2; ++n) bv[bj][n] = bias ? *(const f32x4*)(bias + bcol0 + bj * HALF + 4 * n) : (f32x4){0.f, 0.f, 0.f, 0.f};
#pragma unroll
        for (int ai = 0; ai < 2; ++ai)
#pragma unroll
            for (int m = 0; m < 4; ++m) { bf16_t* rowp = base + (size_t)(row0 + ai * HALF + m * 16) * ldc + col0;
#pragma unroll
                for (int bj = 0; bj < 2; ++bj) { f32x4 v0 = acc[ai][bj][m][0] + bv[bj][0], v1 = acc[ai][bj][m][1] + bv[bj][1];
                    if (ACT == 1) { f32x2 a = gelu_pk((f32x2){v0[0], v0[1]}), b = gelu_pk((f32x2){v0[2], v0[3]}), c = gelu_pk((f32x2){v1[0], v1[1]}), d = gelu_pk((f32x2){v1[2], v1[3]});
                        v0 = (f32x4){a.x, a.y, b.x, b.y}; v1 = (f32x4){c.x, c.y, d.x, d.y}; }
                    v0 = v0 * sc; v1 = v1 * sc; u32x4 w; w.x = cvt_pk_bf16(v0[0], v0[1]); w.y = cvt_pk_bf16(v0[2], v0[3]); w.z = cvt_pk_bf16(v1[0], v1[1]); w.w = cvt_pk_bf16(v1[2], v1[3]);
                    *(u32x4*)(rowp + bj * HALF) = w; } }
    }
};
__device__ __forceinline__ float bf_lo(unsigned u) { return __uint_as_float(u << 16); }
__device__ __forceinline__ float bf_hi(unsigned u) { return __uint_as_float(u & 0xffff0000u); }
struct EpiRes {
    static constexpr bool PERM = true, AFTER_DRAIN = false;
    float* out; const bf16_t* xn; int ldc; float alpha;
    __device__ __forceinline__ void operator()(const f32x4 (&acc)[2][2][4][2], const Unit& u, int wr, int wc, int fr, int fq) const {
        const int row0 = u.pm * BM + wr * 64 + fr, col0 = u.pn * BM + wc * 32 + 8 * fq;
#pragma unroll
        for (int ai = 0; ai < 2; ++ai)
#pragma unroll
            for (int m = 0; m < 4; ++m) { const size_t off = (size_t)(row0 + ai * HALF + m * 16) * ldc + col0;
#pragma unroll
                for (int bj = 0; bj < 2; ++bj) { const u32x4 xv = *(const u32x4*)(xn + off + bj * HALF);
                    const f32x4 a0 = (f32x4){bf_lo(xv.x), bf_hi(xv.x), bf_lo(xv.y), bf_hi(xv.y)}, a1 = (f32x4){bf_lo(xv.z), bf_hi(xv.z), bf_lo(xv.w), bf_hi(xv.w)};
                    *(f32x4*)(out + off + bj * HALF) = acc[ai][bj][m][0] + a0 * alpha;
                    *(f32x4*)(out + off + bj * HALF + 4) = acc[ai][bj][m][1] + a1 * alpha; } }
    }
};
struct PanelOrder {
    int nM, G, c;
    __device__ bool next(int i, Unit& u) const { const int panel = c + (i >> 2) * G; if (panel >= nM) return false; u.pm = panel; u.pn = i & 3; return true; }
    __device__ __forceinline__ void a_ready(const Unit&) const {}
    __device__ __forceinline__ void done(const Unit&) const {}
};
template <class Epi, class Sched, bool ALIGN_EPI = false, bool SP2 = false>
__device__ __forceinline__ void gemm_phase(PG8_LAS unsigned char* lds, const Gemm g, const Sched& S, const Epi& E) {
    const int tid = threadIdx.x, wid = __builtin_amdgcn_readfirstlane(tid >> 6), lane = tid & 63, wr = wid >> 2, wc = wid & 3, fr = lane & 15, fq = lane >> 4;
    const int K = g.K, nt = K / BK;
    unsigned voffA[2], voffB[2];
#pragma unroll
    for (int i = 0; i < 2; ++i) { int R, C; stage_rc(tid * 16 + i * 8192, R, C); const int Rb = Epi::PERM ? ((R & ~31) + perm32(R & 31)) : R;
        voffA[i] = (unsigned)(R * K + C) * 2u; voffB[i] = (unsigned)(Rb * K + C) * 2u; }
    const size_t kstep = (size_t)(BK * 2);
    const size_t hstep = (size_t)HALF * K * 2;
    const size_t tstep = 2 * hstep;
    const unsigned ldsw = (unsigned)wid * 1024u;
    const int aoff = lds_byte(wr * 64 + fr, fq * 8), boff = lds_byte(wc * 32 + fr, fq * 8);
#define PG8_SA(b, h) (((b) * 2 + (h)) * HTB)
#define PG8_SB(b, h) ((4 + (b) * 2 + (h)) * HTB)
#define PG8_STAGE(bufoff, gbase, voff) do { _Pragma("unroll") for (int _i = 0; _i < 2; ++_i) \
        __builtin_amdgcn_global_load_lds((const unsigned*)((const char*)(gbase) + (voff)[_i]), (PG8_LAS unsigned*)(lds + (bufoff) + ldsw + _i * 8192), 16, 0, 0); } while (0)
#define PG8_LDA(dst, b, h) do { _Pragma("unroll") for (int m = 0; m < 4; ++m) _Pragma("unroll") for (int k = 0; k < 2; ++k) dst[m][k] = *(const PG8_LAS bf16x8*)(lds + PG8_SA(b, h) + aoff + m * 2048 + k * 1024); } while (0)
#define PG8_LDB(dst, b, h) do { _Pragma("unroll") for (int n = 0; n < 2; ++n) _Pragma("unroll") for (int k = 0; k < 2; ++k) dst[n][k] = *(const PG8_LAS bf16x8*)(lds + PG8_SB(b, h) + boff + n * 2048 + k * 1024); } while (0)
#define PG8_MMA(ai, bj, At, Bt) do { __builtin_amdgcn_s_setprio(1); _Pragma("unroll") for (int m = 0; m < 4; ++m) _Pragma("unroll") for (int n = 0; n < 2; ++n) _Pragma("unroll") for (int k = 0; k < 2; ++k) \
        acc[ai][bj][m][n] = __builtin_amdgcn_mfma_f32_16x16x32_bf16(Bt[n][k], At[m][k], acc[ai][bj][m][n], 0, 0, 0); __builtin_amdgcn_s_setprio(0); } while (0)
#define PG8_WAIT_V(n) asm volatile("s_waitcnt vmcnt(" #n ")" ::: "memory")
#define PG8_WAIT_L(n) asm volatile("s_waitcnt lgkmcnt(" #n ")" ::: "memory")
#define PG8_BAR __builtin_amdgcn_s_barrier()
#define PG8_SCHED __builtin_amdgcn_sched_barrier(0)
    Unit cur, nxt; int ui = 0;
    if (!S.next(0, cur)) return;
    f32x4 acc[2][2][4][2];
#pragma unroll
    for (int a = 0; a < 2; ++a)
#pragma unroll
        for (int b = 0; b < 2; ++b)
#pragma unroll
            for (int m = 0; m < 4; ++m)
#pragma unroll
                for (int n = 0; n < 2; ++n) acc[a][b][m][n] = (f32x4){0.f, 0.f, 0.f, 0.f};
    bf16x8 At[4][2], B0[2][2], B1[2][2];
    const char* cA = (const char*)g.A + (size_t)cur.pm * tstep; const char* cB = (const char*)g.Bt + (size_t)cur.pn * tstep;
    S.a_ready(cur);
    if constexpr (SP2) {
        PG8_STAGE(PG8_SB(0, 0), cB, voffB); PG8_STAGE(PG8_SB(0, 1), cB + hstep, voffB); PG8_STAGE(PG8_SA(0, 0), cA, voffA); PG8_STAGE(PG8_SA(0, 1), cA + hstep, voffA);
        if (wr == 1) PG8_BAR;
        PG8_WAIT_V(2); PG8_BAR;
        PG8_STAGE(PG8_SB(1, 0), cB + kstep, voffB); PG8_STAGE(PG8_SA(1, 0), cA + kstep, voffA); PG8_STAGE(PG8_SB(1, 1), cB + hstep + kstep, voffB);
        PG8_WAIT_V(6); PG8_BAR;
    } else {
        PG8_STAGE(PG8_SB(0, 0), cB, voffB); PG8_STAGE(PG8_SA(0, 0), cA, voffA); PG8_STAGE(PG8_SB(0, 1), cB + hstep, voffB); PG8_STAGE(PG8_SA(0, 1), cA + hstep, voffA);
        if (wr == 1) PG8_BAR;
        PG8_WAIT_V(4); PG8_BAR;
        PG8_STAGE(PG8_SB(1, 0), cB + kstep, voffB); PG8_STAGE(PG8_SA(1, 0), cA + kstep, voffA); PG8_STAGE(PG8_SB(1, 1), cB + hstep + kstep, voffB);
        PG8_WAIT_V(6); PG8_BAR;
    }
    for (;;) {
        const bool has_next = S.next(ui + 1, nxt);
        const char* nA = has_next ? (const char*)g.A + (size_t)nxt.pm * tstep : cA; const char* nB = has_next ? (const char*)g.Bt + (size_t)nxt.pn * tstep : cB;
        for (int t = 0; t < nt; t += 2) {
            const bool last = (t == nt - 2);
            const char* a1 = cA + (size_t)(t + 1) * kstep;
            const char* a2 = last ? nA : cA + (size_t)(t + 2) * kstep; const char* b2 = last ? nB : cB + (size_t)(t + 2) * kstep;
            const char* a3 = a2 + kstep; const char* b3 = b2 + kstep;
            if (last && has_next) S.a_ready(nxt);
            if constexpr (SP2) {
            PG8_LDB(B0, 0, 0); PG8_LDB(B1, 0, 1); PG8_SCHED; PG8_LDA(At, 0, 0); PG8_STAGE(PG8_SA(1, 1), a1 + hstep, voffA);
            PG8_WAIT_V(8); PG8_WAIT_L(0); PG8_BAR; PG8_MMA(0, 0, At, B0); PG8_MMA(0, 1, At, B1); PG8_BAR; PG8_SCHED;
            PG8_LDA(At, 0, 1); PG8_STAGE(PG8_SB(0, 0), b2, voffB); PG8_STAGE(PG8_SB(0, 1), b2 + hstep, voffB); PG8_STAGE(PG8_SA(0, 0), a2, voffA);
            PG8_WAIT_V(8); PG8_WAIT_L(0); PG8_BAR; PG8_MMA(1, 0, At, B0); PG8_MMA(1, 1, At, B1); PG8_BAR; PG8_SCHED;
            PG8_LDB(B0, 1, 0); PG8_LDB(B1, 1, 1); PG8_SCHED; PG8_LDA(At, 1, 0); PG8_STAGE(PG8_SA(0, 1), a2 + hstep, voffA);
            PG8_WAIT_V(8); PG8_WAIT_L(0); PG8_BAR; PG8_MMA(0, 0, At, B0); PG8_MMA(0, 1, At, B1); PG8_BAR; PG8_SCHED;
            PG8_LDA(At, 1, 1); PG8_STAGE(PG8_SB(1, 0), b3, voffB); PG8_STAGE(PG8_SB(1, 1), b3 + hstep, voffB); PG8_STAGE(PG8_SA(1, 0), a3, voffA);
            PG8_WAIT_V(8); PG8_WAIT_L(0); PG8_BAR; PG8_MMA(1, 0, At, B0); PG8_MMA(1, 1, At, B1); PG8_BAR; PG8_SCHED;
            } else {
            PG8_LDB(B0, 0, 0); PG8_SCHED; PG8_LDA(At, 0, 0); PG8_STAGE(PG8_SA(1, 1), a1 + hstep, voffA);
            PG8_WAIT_L(8); PG8_BAR; PG8_WAIT_L(0); PG8_MMA(0, 0, At, B0); PG8_BAR; PG8_SCHED;
            PG8_LDB(B1, 0, 1); PG8_STAGE(PG8_SB(0, 0), b2, voffB);
            PG8_BAR; PG8_WAIT_L(0); PG8_MMA(0, 1, At, B1); PG8_BAR;
            PG8_LDA(At, 0, 1); PG8_STAGE(PG8_SA(0, 0), a2, voffA);
            PG8_BAR; PG8_WAIT_L(0); PG8_MMA(1, 0, At, B0); PG8_BAR; PG8_SCHED;
            PG8_STAGE(PG8_SB(0, 1), b2 + hstep, voffB);
            PG8_WAIT_V(6); PG8_BAR; PG8_MMA(1, 1, At, B1); PG8_BAR;
            PG8_LDB(B0, 1, 0); PG8_SCHED; PG8_LDA(At, 1, 0); PG8_STAGE(PG8_SA(0, 1), a2 + hstep, voffA);
            PG8_WAIT_L(8); PG8_BAR; PG8_WAIT_L(0); PG8_MMA(0, 0, At, B0); PG8_BAR; PG8_SCHED;
            PG8_LDB(B1, 1, 1); PG8_STAGE(PG8_SB(1, 0), b3, voffB);
            PG8_BAR; PG8_WAIT_L(0); PG8_MMA(0, 1, At, B1); PG8_BAR;
            PG8_LDA(At, 1, 1); PG8_STAGE(PG8_SA(1, 0), a3, voffA);
            PG8_BAR; PG8_WAIT_L(0); PG8_MMA(1, 0, At, B0); PG8_BAR; PG8_SCHED;
            PG8_STAGE(PG8_SB(1, 1), b3 + hstep, voffB);
            PG8_WAIT_V(6); PG8_BAR; PG8_MMA(1, 1, At, B1); PG8_BAR;
            }
        }
        if constexpr (ALIGN_EPI) { if (wr == 0) PG8_BAR; }
        if constexpr (!Epi::AFTER_DRAIN) { E(acc, cur, wr, wc, fr, fq); S.done(cur); }
        if (!has_next) break;
#pragma unroll
        for (int a = 0; a < 2; ++a)
#pragma unroll
            for (int b = 0; b < 2; ++b)
#pragma unroll
                for (int m = 0; m < 4; ++m)
#pragma unroll
                    for (int n = 0; n < 2; ++n) acc[a][b][m][n] = (f32x4){0.f, 0.f, 0.f, 0.f};
        cur = nxt; cA = nA; cB = nB; ++ui;
        if constexpr (ALIGN_EPI) { if (wr == 1) PG8_BAR; }
    }
    PG8_WAIT_V(0);
    if constexpr (!ALIGN_EPI) { if (wr == 0) PG8_BAR; }
    PG8_BAR;
    if constexpr (Epi::AFTER_DRAIN) { E.fused(acc, cur, wr, wc, fr, fq, lds, wid, lane); S.done(cur); }
#undef PG8_SA
#undef PG8_SB
#undef PG8_STAGE
#undef PG8_LDA
#undef PG8_LDB
#undef PG8_MMA
#undef PG8_WAIT_V
#undef PG8_WAIT_L
#undef PG8_BAR
#undef PG8_SCHED
}
}

constexpr int NB = 32, SEQ = 2048, DM = 1024, MROWS = NB * SEQ;
constexpr int GW = 512, NHEAD = 8, HD = 64, CHUNK = 64, LEFTC = 8;
constexpr int LDP = 3584;
constexpr int COL_Q = 0, COL_K = 512, COL_ZA = 1024, COL_B = 1536, COL_C = 2048, COL_H = 2560, COL_ZC = 3072;
constexpr int LDV = MROWS;
constexpr float LN_EPS = 1e-5f;
constexpr float ALPHA = 1.189207115002721f;
constexpr float LOG2E = 1.4426950408889634f;
constexpr int TABN = 320;

constexpr size_t MiB = 1u << 20;
constexpr size_t WS_W1T = 0, WS_WVT = 8 * MiB, WS_W2T = 10 * MiB, WS_XN = 16 * MiB, WS_PROJ = 144 * MiB, WS_VT = 592 * MiB, WS_Y = 656 * MiB, WS_END = 784 * MiB;

constexpr int NWAVES = 8;
constexpr int RING_BYTES = 131072, MISC_OFF = RING_BYTES, LDS_BYTES = 147456;

#define LAS __attribute__((address_space(3)))
typedef unsigned short bf16;
typedef unsigned v4u __attribute__((ext_vector_type(4)));
typedef unsigned v2u __attribute__((ext_vector_type(2)));
typedef float f32x4 __attribute__((ext_vector_type(4)));
typedef float f32x16 __attribute__((ext_vector_type(16)));
typedef short bf16x8 __attribute__((ext_vector_type(8)));
typedef float f32x2_t __attribute__((ext_vector_type(2)));
typedef __bf16 bf16x2_t __attribute__((ext_vector_type(2)));

__device__ __forceinline__ unsigned cvtpk(float lo, float hi) { f32x2_t v = {lo, hi}; bf16x2_t b = __builtin_convertvector(v, bf16x2_t); return __builtin_bit_cast(unsigned, b); }
__device__ __forceinline__ float bflo(unsigned u) { return __uint_as_float(u << 16); }
__device__ __forceinline__ float bfhi(unsigned u) { return __uint_as_float(u & 0xffff0000u); }
__device__ __forceinline__ float silu_f(float z) { return z * __builtin_amdgcn_rcpf(1.0f + __builtin_amdgcn_exp2f(-z * LOG2E)); }
__device__ __forceinline__ float wave_sum(float v) {
#pragma unroll
    for (int o = 1; o < 64; o <<= 1) v += __shfl_xor(v, o);
    return v;
}

__device__ __forceinline__ void p0_transpose_item(const float* W, int K, int N, bf16* dst  , LAS float* scr, int k0, int n0, int lane) {
#pragma unroll 8
    for (int i = 0; i < 32; ++i) { const int kk = 2 * i + (lane >> 5); scr[kk * 33 + (lane & 31)] = W[(size_t)(k0 + kk) * N + n0 + (lane & 31)]; }
    asm volatile("s_waitcnt lgkmcnt(0)" ::: "memory");
    const int c = lane & 7;
#pragma unroll
    for (int j = 0; j < 4; ++j) { const int n = (lane >> 3) + 8 * j; const LAS float* s = scr + (8 * c) * 33 + n;
        v4u o; o.x = cvtpk(s[0 * 33], s[1 * 33]); o.y = cvtpk(s[2 * 33], s[3 * 33]); o.z = cvtpk(s[4 * 33], s[5 * 33]); o.w = cvtpk(s[6 * 33], s[7 * 33]);
        *(v4u*)(dst + (size_t)n * K + k0 + 8 * c) = o; }
    asm volatile("s_waitcnt lgkmcnt(0)" ::: "memory");
}
__device__ __forceinline__ void ln_row_to_bf16(const float* xrow, const float* g, const float* bt, bf16* orow, int lane) {
    const f32x4* xr = (const f32x4*)xrow + lane;
    f32x4 v[4]; float s = 0.f;
#pragma unroll
    for (int j = 0; j < 4; ++j) { v[j] = xr[64 * j]; s += (v[j].x + v[j].y) + (v[j].z + v[j].w); }
    const float mean = wave_sum(s) * (1.f / DM); float s2 = 0.f;
#pragma unroll
    for (int j = 0; j < 4; ++j) { v[j] = v[j] - mean; s2 += (v[j].x * v[j].x + v[j].y * v[j].y) + (v[j].z * v[j].z + v[j].w * v[j].w); }
    const float rstd = 1.f / sqrtf(wave_sum(s2) * (1.f / DM) + LN_EPS);
    v2u* o8 = (v2u*)orow + lane;
#pragma unroll
    for (int j = 0; j < 4; ++j) { const f32x4 gg = ((const f32x4*)g)[lane + 64 * j], bb = ((const f32x4*)bt)[lane + 64 * j]; const f32x4 y = v[j] * rstd * gg + bb;
        v2u w; w.x = cvtpk(y.x, y.y); w.y = cvtpk(y.z, y.w); o8[64 * j] = w; }
}
__device__ __forceinline__ void ln_row_inplace(float* row, const float* g, const float* bt, int lane) {
    f32x4* xr = (f32x4*)row + lane;
    f32x4 v[4]; float s = 0.f;
#pragma unroll
    for (int j = 0; j < 4; ++j) { v[j] = xr[64 * j]; s += (v[j].x + v[j].y) + (v[j].z + v[j].w); }
    const float mean = wave_sum(s) * (1.f / DM); float s2 = 0.f;
#pragma unroll
    for (int j = 0; j < 4; ++j) { v[j] = v[j] - mean; s2 += (v[j].x * v[j].x + v[j].y * v[j].y) + (v[j].z * v[j].z + v[j].w * v[j].w); }
    const float rstd = 1.f / sqrtf(wave_sum(s2) * (1.f / DM) + LN_EPS);
#pragma unroll
    for (int j = 0; j < 4; ++j) { const f32x4 gg = ((const f32x4*)g)[lane + 64 * j], bb = ((const f32x4*)bt)[lane + 64 * j]; xr[64 * j] = v[j] * rstd * gg + bb; }
}

#define MFMA32(a, b, c) __builtin_amdgcn_mfma_f32_32x32x16_bf16((a), (b), (c), 0, 0, 0)
constexpr int ATT_NSLOT = 6, ATT_SLOTB = 8192, ATT_LDS_V = ATT_NSLOT * ATT_SLOTB, ATT_LDS_TAB = 2 * ATT_NSLOT * ATT_SLOTB;
__device__ __forceinline__ void glds16(const void* gsrc, unsigned lds_dst) { unsigned keep;
    asm volatile("s_mov_b32 %0, m0\n\ts_mov_b32 m0, %2\n\ts_nop 0\n\tglobal_load_lds_dwordx4 %1, off\n\ts_mov_b32 m0, %0" : "=&s"(keep) : "v"(gsrc), "s"(lds_dst) : "memory"); }
#define ATT_WAIT_BAR(N) asm volatile("s_waitcnt vmcnt(" #N ") lgkmcnt(0)\n\ts_barrier" ::: "memory")
#define ATT_BAR() asm volatile("s_waitcnt lgkmcnt(0)\n\ts_barrier" ::: "memory")
__device__ __forceinline__ void attn_group(int b, int h, int g, const bf16* __restrict__ PJ, const bf16* __restrict__ VT, bf16* __restrict__ Y, LAS unsigned char* lds, int wid, int lane) {
    const int q32 = lane & 31, hi = lane >> 5, cw = wid >> 1, half = wid & 1;
    const int pk = (q32 & 0x13) | ((q32 & 4) << 1) | ((q32 & 8) >> 1);
    const int c0 = 4 * g, base = c0 - 8, tmax = c0 + 3;
    const size_t brow = (size_t)b * SEQ;
    const size_t qrow = brow + (size_t)(c0 + cw) * CHUNK + half * 32 + q32;
    const LAS float* tab = (const LAS float*)(lds + ATT_LDS_TAB);
    bf16x8 qf[4];
#pragma unroll
    for (int d0 = 0; d0 < 4; ++d0) qf[d0] = *(const bf16x8*)(PJ + qrow * LDP + COL_Q + h * HD + d0 * 16 + hi * 8);
    const bf16* ksrc = PJ + (brow + lane) * LDP + COL_K + h * HD + wid * 8;
    const bf16* vsrc = VT + (size_t)(h * HD + lane) * LDV + brow + wid * 8;
    const unsigned lds0 = (unsigned)(uintptr_t)lds;
    const unsigned kdst = lds0 + wid * 1024, vdst = lds0 + ATT_LDS_V + wid * 1024;
#define DMA_TILE(i) do { int T_ = base + (i); T_ = T_ < 0 ? 0 : (T_ > tmax ? tmax : T_); \
        glds16(ksrc + (size_t)T_ * CHUNK * LDP, (unsigned)__builtin_amdgcn_readfirstlane(kdst + ((i) % ATT_NSLOT) * ATT_SLOTB)); \
        glds16(vsrc + (size_t)T_ * CHUNK, (unsigned)__builtin_amdgcn_readfirstlane(vdst + ((i) % ATT_NSLOT) * ATT_SLOTB)); } while (0)
    DMA_TILE(0); DMA_TILE(1); DMA_TILE(2); DMA_TILE(3); DMA_TILE(4); DMA_TILE(5);
    f32x16 o[2], negm;
#pragma unroll
    for (int r = 0; r < 16; ++r) { o[0][r] = 0.f; o[1][r] = 0.f; negm[r] = 0.f; }
    float mref = 0.f, lsum = 0.f; bool started = false;
    ATT_WAIT_BAR(4);
#define ATT_STEP(s) do { \
    const int T_s = base + (s) + cw; \
    if (T_s >= 0) { \
        const unsigned so_ = (unsigned)(((s) + cw) % ATT_NSLOT) * ATT_SLOTB; \
        const LAS unsigned char* kb_ = lds + so_ + hi * 1024 + pk * 16; \
        f32x16 sA = negm, sB = negm; \
        _Pragma("unroll") for (int d0 = 0; d0 < 4; ++d0) { const bf16x8 k0_ = *(const LAS bf16x8*)(kb_ + d0 * 2048), k1_ = *(const LAS bf16x8*)(kb_ + d0 * 2048 + 512); \
            sA = MFMA32(k0_, qf[d0], sA); sB = MFMA32(k1_, qf[d0], sB); } \
        if ((s) >= 6) { const LAS float* tb_ = tab + (128 + 64 * (8 - (s)) + half * 32 + q32 - 8 * hi); \
            _Pragma("unroll") for (int r = 0; r < 16; ++r) { sA[r] += tb_[-(16 * (r >> 3) + (r & 7))]; sB[r] += tb_[-32 - (16 * (r >> 3) + (r & 7))]; } } \
        float rm_ = fmaxf(sA[0], sB[0]); \
        _Pragma("unroll") for (int r = 1; r < 16; ++r) rm_ = fmaxf(rm_, fmaxf(sA[r], sB[r])); \
        rm_ = fmaxf(rm_, __shfl_xor(rm_, 32)); \
        const bool need_ = started ? (rm_ > 8.f) : true; \
        if (__any(need_)) { const float d_ = need_ ? rm_ : 0.f; mref += d_; const float f_ = __builtin_amdgcn_exp2f(-d_); lsum *= f_; \
            _Pragma("unroll") for (int r = 0; r < 16; ++r) { o[0][r] *= f_; o[1][r] *= f_; sA[r] -= d_; sB[r] -= d_; negm[r] = -mref; } } \
        started = true; \
        float ps_ = 0.f; \
        _Pragma("unroll") for (int r = 0; r < 16; ++r) { sA[r] = __builtin_amdgcn_exp2f(sA[r]); sB[r] = __builtin_amdgcn_exp2f(sB[r]); ps_ += sA[r] + sB[r]; } \
        lsum += ps_; \
        bf16x8 pf_[4]; \
        { v4u w_; w_.x = cvtpk(sA[0], sA[1]); w_.y = cvtpk(sA[2], sA[3]); w_.z = cvtpk(sA[4], sA[5]); w_.w = cvtpk(sA[6], sA[7]); pf_[0] = __builtin_bit_cast(bf16x8, w_); \
          w_.x = cvtpk(sA[8], sA[9]); w_.y = cvtpk(sA[10], sA[11]); w_.z = cvtpk(sA[12], sA[13]); w_.w = cvtpk(sA[14], sA[15]); pf_[1] = __builtin_bit_cast(bf16x8, w_); \
          w_.x = cvtpk(sB[0], sB[1]); w_.y = cvtpk(sB[2], sB[3]); w_.z = cvtpk(sB[4], sB[5]); w_.w = cvtpk(sB[6], sB[7]); pf_[2] = __builtin_bit_cast(bf16x8, w_); \
          w_.x = cvtpk(sB[8], sB[9]); w_.y = cvtpk(sB[10], sB[11]); w_.z = cvtpk(sB[12], sB[13]); w_.w = cvtpk(sB[14], sB[15]); pf_[3] = __builtin_bit_cast(bf16x8, w_); } \
        const LAS unsigned char* vb_ = lds + ATT_LDS_V + so_ + hi * 1024 + q32 * 16; \
        _Pragma("unroll") for (int sl = 0; sl < 4; ++sl) { const bf16x8 v0_ = *(const LAS bf16x8*)(vb_ + sl * 2048), v1_ = *(const LAS bf16x8*)(vb_ + sl * 2048 + 512); \
            o[0] = MFMA32(v0_, pf_[sl], o[0]); o[1] = MFMA32(v1_, pf_[sl], o[1]); } \
    } } while (0)
    ATT_STEP(0); ATT_WAIT_BAR(2); DMA_TILE(6);
    ATT_STEP(1); ATT_WAIT_BAR(2); DMA_TILE(7);
    ATT_STEP(2); ATT_WAIT_BAR(2); DMA_TILE(8);
    ATT_STEP(3); ATT_WAIT_BAR(2); DMA_TILE(9);
    ATT_STEP(4); ATT_WAIT_BAR(2); DMA_TILE(10);
    ATT_STEP(5); ATT_WAIT_BAR(2); DMA_TILE(11);
    ATT_STEP(6); ATT_WAIT_BAR(2);
    ATT_STEP(7); ATT_WAIT_BAR(0);
    ATT_STEP(8); ATT_BAR();
#undef ATT_STEP
#undef DMA_TILE
    {
        const float lt = lsum + __shfl_xor(lsum, 32);
        const float inv = 1.0f / lt;
#pragma unroll
        for (int db = 0; db < 2; ++db)
#pragma unroll
            for (int gg = 0; gg < 4; ++gg) {
                const int d = db * 32 + 8 * gg + 4 * hi;
                const v2u z = *(const v2u*)(PJ + qrow * LDP + COL_ZA + h * HD + d);
                const float y0 = o[db][4 * gg + 0] * inv * silu_f(bflo(z.x)), y1 = o[db][4 * gg + 1] * inv * silu_f(bfhi(z.x));
                const float y2 = o[db][4 * gg + 2] * inv * silu_f(bflo(z.y)), y3 = o[db][4 * gg + 3] * inv * silu_f(bfhi(z.y));
                v2u w; w.x = cvtpk(y0, y1); w.y = cvtpk(y2, y3);
                *(v2u*)(Y + qrow * DM + h * HD + d) = w;
            }
    }
    asm volatile("s_waitcnt vmcnt(0)" ::: "memory");
}

__device__ __forceinline__ void unpack8(const v4u v, float (&f)[8]) { f[0] = bflo(v.x); f[1] = bfhi(v.x); f[2] = bflo(v.y); f[3] = bfhi(v.y); f[4] = bflo(v.z); f[5] = bfhi(v.z); f[6] = bflo(v.w); f[7] = bfhi(v.w); }
__device__ __forceinline__ void conv_strip(size_t tok0, int ntok, bool seq_start, const bf16* __restrict__ PJ, bf16* __restrict__ Y, const float* __restrict__ cw, const float* __restrict__ cbv, int lane) {
    const int ch0 = lane * 8;
    float w0[8], w1[8], w2[8], bb[8], u1[8], u2[8];
#pragma unroll
    for (int e = 0; e < 8; ++e) { w0[e] = cw[ch0 + e]; w1[e] = cw[GW + ch0 + e]; w2[e] = cw[2 * GW + ch0 + e]; bb[e] = cbv[ch0 + e]; u1[e] = 0.f; u2[e] = 0.f; }
    if (!seq_start) {
        float c1[8], h1[8], c2[8], h2[8];
        unpack8(*(const v4u*)(PJ + (tok0 - 1) * LDP + COL_C + ch0), c1); unpack8(*(const v4u*)(PJ + (tok0 - 1) * LDP + COL_H + ch0), h1);
        unpack8(*(const v4u*)(PJ + (tok0 - 2) * LDP + COL_C + ch0), c2); unpack8(*(const v4u*)(PJ + (tok0 - 2) * LDP + COL_H + ch0), h2);
#pragma unroll
        for (int e = 0; e < 8; ++e) { u1[e] = c1[e] * h1[e]; u2[e] = c2[e] * h2[e]; }
    }
#pragma unroll 4
    for (int t = 0; t < ntok; ++t) {
        const bf16* pr = PJ + (tok0 + t) * LDP + ch0;
        float bv[8], cv[8], hv[8], zv[8], y[8];
        unpack8(*(const v4u*)(pr + COL_B), bv); unpack8(*(const v4u*)(pr + COL_C), cv); unpack8(*(const v4u*)(pr + COL_H), hv); unpack8(*(const v4u*)(pr + COL_ZC), zv);
#pragma unroll
        for (int e = 0; e < 8; ++e) { const float u0 = cv[e] * hv[e]; const float cvv = bb[e] + w0[e] * u2[e] + w1[e] * u1[e] + w2[e] * u0; y[e] = bv[e] * cvv * silu_f(zv[e]); u2[e] = u1[e]; u1[e] = u0; }
        v4u w; w.x = cvtpk(y[0], y[1]); w.y = cvtpk(y[2], y[3]); w.z = cvtpk(y[4], y[5]); w.w = cvtpk(y[6], y[7]);
        *(v4u*)(Y + (tok0 + t) * DM + GW + ch0) = w;
    }
}

struct Args { const float* x; const float* ln0g; const float* ln0b; const float* win; const float* relb; const float* convw; const float* convb; const float* wout; const float* lng; const float* lnb;
              float* out; unsigned char* ws; int ph_lo, ph_hi; };
#ifndef MK_NLAUNCH
#define MK_NLAUNCH 1
#endif
constexpr int NPHASE = 4;
#ifndef REP_P0
#define REP_P0 1
#endif
#ifndef REP_P3
#define REP_P3 1
#endif
#ifndef REP_P1
#define REP_P1 1
#endif
#ifndef REP_P2
#define REP_P2 1
#endif

#ifndef LB2
#define LB2 2
#endif
__global__ void __launch_bounds__(NWAVES * 64, LB2) fwd_megakernel(Args a) {
    extern __shared__ __attribute__((aligned(16))) unsigned char lds_raw[];
    LAS unsigned char* lds = (LAS unsigned char*)lds_raw;
    volatile LAS unsigned* MISC = (volatile LAS unsigned*)(lds + MISC_OFF);
    cg::grid_group grid = cg::this_grid();
    const int tid = threadIdx.x, lane = tid & 63, wave = __builtin_amdgcn_readfirstlane(tid >> 6);
    const int G = gridDim.x, bx = blockIdx.x;
    unsigned char* ws = a.ws;
    bf16* W1T = (bf16*)(ws + WS_W1T); bf16* WVT = (bf16*)(ws + WS_WVT); bf16* W2T = (bf16*)(ws + WS_W2T);
    bf16* XN = (bf16*)(ws + WS_XN); bf16* PJ = (bf16*)(ws + WS_PROJ); bf16* VT = (bf16*)(ws + WS_VT); bf16* Y = (bf16*)(ws + WS_Y);
    if (tid < 64) MISC[tid] = 0u;
    __syncthreads();
    const int lo = a.ph_lo, hi = a.ph_hi;
#ifdef ONLY_P2
#define IN(k) ((k) == 2 && lo <= 2)
#else
#define IN(k) (lo <= (k) && (k) < hi)
#endif
#define SEAM(k) do { if (IN(k) && IN((k) + 1)) grid.sync(); } while (0)

    for (int rep0 = 0; rep0 < REP_P0; ++rep0)
    if (IN(0)) {
        LAS float* scr = (LAS float*)(lds + wave * 16384);
        const int gw = bx * NWAVES + wave, NGW = G * NWAVES;
        constexpr int I_IN = (DM / 64) * (4096 / 32), I_OUT = (DM / 64) * (DM / 32);
        for (int it = gw; it < I_IN + I_OUT; it += NGW) {
            if (it < I_IN) { const int kb = it / 128, nb = it % 128, n0 = nb * 32, grp = n0 / GW, within = n0 % GW;
                bf16* dst = (grp == 2) ? (WVT + (size_t)within * DM) : (W1T + (size_t)((grp < 2 ? grp : grp - 1) * GW + within) * DM);
                p0_transpose_item(a.win, DM, 4096, dst, scr, kb * 64, n0, lane); }
            else { const int r = it - I_IN, kb = r / 32, nb = r % 32; p0_transpose_item(a.wout, DM, DM, W2T + (size_t)(nb * 32) * DM, scr, kb * 64, nb * 32, lane); }
        }
        for (int m = gw; m < MROWS; m += NGW) ln_row_to_bf16(a.x + (size_t)m * DM, a.ln0g, a.ln0b, XN + (size_t)m * DM, lane);
    }
    SEAM(0);

    for (int rep1 = 0; rep1 < REP_P1; ++rep1)
    if (IN(1)) {
        { pg8::Gemm g{XN, W1T, MROWS, LDP, DM}; pg8::StaticOrder S; S.init(MROWS, LDP, G, bx);
          pg8::EpiBf16<0> E{PJ, LDP, nullptr, GW, (size_t)GW, 0.125f * LOG2E};
          pg8::gemm_phase<pg8::EpiBf16<0>, pg8::StaticOrder, true, true>(lds, g, S, E); }
        { pg8::Gemm g{WVT, XN, GW, MROWS, DM}; pg8::StaticOrder S; S.init(GW, MROWS, G, bx);
          pg8::EpiBf16<0> E{VT, LDV, nullptr, 0, 0, 1.f};
          pg8::gemm_phase<pg8::EpiBf16<0>, pg8::StaticOrder, true, true>(lds, g, S, E); }
    }
    SEAM(1);

    for (int rep2 = 0; rep2 < REP_P2; ++rep2)
    if (IN(2)) {
        if (rep2 > 0) { if (tid < 64) MISC[tid] = 0u; __syncthreads(); }
        for (int bh = bx; bh < NB * NHEAD; bh += G) {
            const int b = bh >> 3, h = bh & 7;
            LAS float* tab = (LAS float*)(lds + ATT_LDS_TAB);
            __syncthreads();
            for (int i = tid; i < TABN; i += NWAVES * 64) tab[i] = (a.relb[h * 257 + (i < 256 ? i : 256)] - a.relb[h * 257 + 256]) * LOG2E;
            __syncthreads();
            for (int g = 0; g < 8; ++g) attn_group(b, h, g, PJ, VT, Y, lds, wave, lane);
            { const size_t tok0 = (size_t)bh * 256 + (size_t)wave * 32; conv_strip(tok0, 32, (tok0 % SEQ) == 0, PJ, Y, a.convw, a.convb, lane); }
        }
        __syncthreads();
    }
    SEAM(2);

    for (int rep3 = 0; rep3 < REP_P3; ++rep3)
    if (IN(3)) {
        pg8::Gemm g{Y, W2T, MROWS, DM, DM}; pg8::PanelOrder S{MROWS / 256, G, bx};
        pg8::EpiRes E{a.out, XN, DM, ALPHA};
        pg8::gemm_phase<pg8::EpiRes, pg8::PanelOrder, true, true>(lds, g, S, E);
        asm volatile("s_waitcnt vmcnt(0)" ::: "memory");
        __syncthreads();
        __builtin_amdgcn_fence(__ATOMIC_ACQUIRE, "agent");
        for (int panel = bx; panel < MROWS / 256; panel += G)
            for (int r = wave; r < 256; r += NWAVES) ln_row_inplace(a.out + ((size_t)panel * 256 + r) * DM, a.lng, a.lnb, lane);
    }
#undef IN
#undef SEAM
}

extern "C" void kernel_launch(void* const* d_in, const int* in_sizes, int n_in, void* d_out, int out_size, void* d_ws, size_t ws_size, hipStream_t stream) {
    static int grid = 0;
    if (grid == 0) {
        if (n_in != 10 || in_sizes[0] != MROWS * DM || out_size != MROWS * DM || ws_size < WS_END) { fprintf(stderr, "kernel_launch: unexpected shapes / workspace (n_in %d, ws %zu)\n", n_in, ws_size); grid = -1; return; }
        int dev = 0, cus = 0, per_cu = 0;
        if (hipGetDevice(&dev) != hipSuccess || hipDeviceGetAttribute(&cus, hipDeviceAttributeMultiprocessorCount, dev) != hipSuccess) { grid = -1; return; }
        if (hipFuncSetAttribute((const void*)fwd_megakernel, hipFuncAttributeMaxDynamicSharedMemorySize, LDS_BYTES) != hipSuccess) { fprintf(stderr, "kernel_launch: hipFuncSetAttribute failed\n"); grid = -1; return; }
        if (hipOccupancyMaxActiveBlocksPerMultiprocessor(&per_cu, (const void*)fwd_megakernel, NWAVES * 64, LDS_BYTES) != hipSuccess || per_cu < 1) { fprintf(stderr, "kernel_launch: occupancy query says %d\n", per_cu); per_cu = 1; }
        (void)hipGetLastError();
        grid = cus;
    }
    if (grid < 0) return;
    Args a{};
    a.x = (const float*)d_in[0]; a.ln0g = (const float*)d_in[1]; a.ln0b = (const float*)d_in[2]; a.win = (const float*)d_in[3]; a.relb = (const float*)d_in[4];
    a.convw = (const float*)d_in[5]; a.convb = (const float*)d_in[6]; a.wout = (const float*)d_in[7]; a.lng = (const float*)d_in[8]; a.lnb = (const float*)d_in[9];
    a.out = (float*)d_out; a.ws = (unsigned char*)d_ws;
    for (int li = 0; li < MK_NLAUNCH; ++li) {
        a.ph_lo = (MK_NLAUNCH == 1) ? 0 : li; a.ph_hi = (MK_NLAUNCH == 1) ? NPHASE : li + 1;
        void* args[] = {&a};
        const hipError_t e = hipLaunchCooperativeKernel((const void*)fwd_megakernel, dim3(grid), dim3(NWAVES * 64), args, LDS_BYTES, stream);
        if (e != hipSuccess) { fprintf(stderr, "kernel_launch: cooperative launch failed: %s (grid %d)\n", hipGetErrorString(e), grid); break; }
    }
}
```
